# Optimizing an MI355X kernel written in HIP

```python
import jax, jax.numpy as jnp
from jax import lax
import numpy as np

D_MODEL = 1024
BATCH = 8
SEQ = 2048
DEPTH = 1
DEC_BATCH = 32
DEC_SEQ = 4
PAST_LEN = 16384
PAGE_SIZE = 128

D_MLA = D_MODEL // 2
D_CONV = D_MODEL - D_MLA
N_HEADS = 8
QK_NOPE = 64
QK_ROPE = 32
V_HEAD = D_MLA // N_HEADS
Q_LORA = 384
KV_LORA = 256
CONV_W = 3
ROPE_THETA = 10000.0
EPS = 1e-6
Q_BLOCK = 128
ATTN_SCALE = (QK_NOPE + QK_ROPE) ** -0.5
IN_SIZES = (Q_LORA, KV_LORA, QK_ROPE, D_MLA, D_CONV, D_CONV, D_CONV, D_CONV)
D_IN = Q_LORA + KV_LORA + QK_ROPE + D_MLA + 4 * D_CONV

kernel_name = "hymba_mla_shortconv_decode_step"


def rmsnorm(x, g):
    xf = x.astype(jnp.float32)
    y = xf * lax.rsqrt(jnp.mean(xf * xf, axis=-1, keepdims=True) + EPS) * g.astype(jnp.float32)
    return y.astype(x.dtype)


def rope(x, pos):
    r = x.shape[-1]
    inv_freq = ROPE_THETA ** (-jnp.arange(0, r, 2, dtype=jnp.float32) / r)
    ang = pos.astype(jnp.float32)[:, None] * inv_freq[None, :]
    ang = jnp.concatenate([ang, ang], axis=-1)
    shape = (1, x.shape[1]) + (1,) * (x.ndim - 3) + (r,)
    cos = jnp.cos(ang).reshape(shape)
    sin = jnp.sin(ang).reshape(shape)
    xf = x.astype(jnp.float32)
    x1, x2 = xf[..., : r // 2], xf[..., r // 2:]
    rot = jnp.concatenate([-x2, x1], axis=-1)
    return (xf * cos + rot * sin).astype(x.dtype)


def split_points():
    pts, acc = [], 0
    for s in IN_SIZES[:-1]:
        acc += s
        pts.append(acc)
    return pts


def branch_inputs(xn, pos, w_in, g_qnorm, w_uq, g_kvnorm, w_ukv):
    b, t = xn.shape[0], xn.shape[1]
    z = xn @ w_in
    c_q, c_kv, k_pe, g_mla, b_gate, c_gate, h, g_conv = jnp.split(z, split_points(), axis=-1)
    q = (rmsnorm(c_q, g_qnorm) @ w_uq).reshape(b, t, N_HEADS, QK_NOPE + QK_ROPE)
    q_nope, q_pe = q[..., :QK_NOPE], rope(q[..., QK_NOPE:], pos)
    ckv = rmsnorm(c_kv, g_kvnorm)
    kpe = rope(k_pe, pos)
    w_uk = w_ukv.reshape(KV_LORA, N_HEADS, QK_NOPE + V_HEAD)[..., :QK_NOPE]
    q_lat = jnp.einsum('bthn,chn->bthc', q_nope, w_uk)
    u = c_gate * h
    return q_lat, q_pe, ckv, kpe, g_mla, b_gate, u, g_conv


def mla_attend(q_lat, q_pe, ckv, kpe, q_pos, k_pos):
    s = jnp.einsum('bqhc,bkc->bhqk', q_lat, ckv) + jnp.einsum('bqhr,bkr->bhqk', q_pe, kpe)
    s = s.astype(jnp.float32) * ATTN_SCALE
    mask = k_pos[None, :] <= q_pos[:, None]
    s = jnp.where(mask[None, None], s, -jnp.inf)
    p = jax.nn.softmax(s, axis=-1).astype(ckv.dtype)
    return jnp.einsum('bhqk,bkc->bqhc', p, ckv)


def prompt_attention(q_lat, q_pe, ckv, kpe, pos):
    b, s = q_lat.shape[0], q_lat.shape[1]
    nb = s // Q_BLOCK
    qb = q_lat.reshape(b, nb, Q_BLOCK, N_HEADS, KV_LORA).transpose(1, 0, 2, 3, 4)
    pb = q_pe.reshape(b, nb, Q_BLOCK, N_HEADS, QK_ROPE).transpose(1, 0, 2, 3, 4)
    posb = pos.reshape(nb, Q_BLOCK)
    o = lax.map(lambda a: mla_attend(a[0], a[1], ckv, kpe, a[2], pos), (qb, pb, posb))
    return o.transpose(1, 0, 2, 3, 4).reshape(b, s, N_HEADS, KV_LORA)


def short_conv(u_pad, w_conv):
    t = u_pad.shape[1] - (CONV_W - 1)
    y = w_conv[0] * u_pad[:, 0:t]
    for k in range(1, CONV_W):
        y = y + w_conv[k] * u_pad[:, k:k + t]
    return y


def branch_output(o_lat, g_mla, y_conv, b_gate, g_conv, w_ukv, w_out, g_post):
    b, t = o_lat.shape[0], o_lat.shape[1]
    w_uv = w_ukv.reshape(KV_LORA, N_HEADS, QK_NOPE + V_HEAD)[..., QK_NOPE:]
    o = jnp.einsum('bthc,chv->bthv', o_lat, w_uv).reshape(b, t, D_MLA)
    mix = jnp.concatenate([o * jax.nn.silu(g_mla), b_gate * y_conv * jax.nn.silu(g_conv)], axis=-1)
    return rmsnorm(mix @ w_out, g_post)


def setup_inputs(seed: int = 0) -> dict:
    key = jax.random.key(seed)
    ks = jax.random.split(key, 20)
    n_pages = PAST_LEN // PAGE_SIZE
    n_used = DEC_BATCH * n_pages
    n_phys = n_used + n_used // 4
    f32 = jnp.float32

    def w(k, shape, fan_in):
        return jax.random.normal(k, shape, f32) * fan_in ** -0.5

    def gain(k, d):
        return 1.0 + 0.02 * jax.random.normal(k, (DEPTH, d), f32)

    page_table = jax.random.permutation(ks[0], n_phys)[:n_used].reshape(DEC_BATCH, n_pages).astype(jnp.int32)
    return {
        "x_prompt": jax.random.normal(ks[1], (BATCH, SEQ, D_MODEL), f32),
        "x_sample": jax.random.normal(ks[2], (DEC_BATCH, DEC_SEQ, D_MODEL), f32),
        "cache_ckv": jax.random.normal(ks[3], (DEPTH, n_phys, PAGE_SIZE, KV_LORA), f32),
        "cache_kpe": jax.random.normal(ks[4], (DEPTH, n_phys, PAGE_SIZE, QK_ROPE), f32),
        "state_conv": jax.random.normal(ks[5], (DEPTH, DEC_BATCH, CONV_W - 1, D_CONV), f32),
        "page_table": page_table,
        "g_pre": gain(ks[6], D_MODEL),
        "w_in": w(ks[7], (DEPTH, D_MODEL, D_IN), D_MODEL),
        "g_qnorm": gain(ks[8], Q_LORA),
        "w_uq": w(ks[9], (DEPTH, Q_LORA, N_HEADS * (QK_NOPE + QK_ROPE)), Q_LORA),
        "g_kvnorm": gain(ks[10], KV_LORA),
        "w_ukv": w(ks[11], (DEPTH, KV_LORA, N_HEADS * (QK_NOPE + V_HEAD)), KV_LORA),
        "w_conv": w(ks[12], (DEPTH, CONV_W, D_CONV), CONV_W),
        "w_out": w(ks[13], (DEPTH, D_MODEL, D_MODEL), D_MODEL),
        "g_post": gain(ks[14], D_MODEL),
    }


def reference(x_prompt, x_sample, cache_ckv, cache_kpe, state_conv, page_table,
              g_pre, w_in, g_qnorm, w_uq, g_kvnorm, w_ukv, w_conv, w_out, g_post):
    pos_p = jnp.arange(SEQ, dtype=jnp.int32)
    pos_s = PAST_LEN + jnp.arange(DEC_SEQ, dtype=jnp.int32)
    k_pos_s = jnp.arange(PAST_LEN + DEC_SEQ, dtype=jnp.int32)
    xp, xs = x_prompt, x_sample
    ckv_p_l, kpe_p_l, conv_p_l, ckv_s_l, kpe_s_l, conv_s_l = [], [], [], [], [], []
    for l in range(DEPTH):
        q_lat, q_pe, ckv, kpe, g_mla, b_gate, u, g_conv = branch_inputs(
            rmsnorm(xp, g_pre[l]), pos_p, w_in[l], g_qnorm[l], w_uq[l], g_kvnorm[l], w_ukv[l])
        o_lat = prompt_attention(q_lat, q_pe, ckv, kpe, pos_p)
        u_pad = jnp.concatenate([jnp.zeros((u.shape[0], CONV_W - 1, D_CONV), u.dtype), u], axis=1)
        y_conv = short_conv(u_pad, w_conv[l])
        xp = xp + branch_output(o_lat, g_mla, y_conv, b_gate, g_conv, w_ukv[l], w_out[l], g_post[l])
        ckv_p_l.append(ckv)
        kpe_p_l.append(kpe)
        conv_p_l.append(u_pad[:, -(CONV_W - 1):])
        q_lat, q_pe, ckv, kpe, g_mla, b_gate, u, g_conv = branch_inputs(
            rmsnorm(xs, g_pre[l]), pos_s, w_in[l], g_qnorm[l], w_uq[l], g_kvnorm[l], w_ukv[l])
        past_ckv = cache_ckv[l][page_table].reshape(DEC_BATCH, PAST_LEN, KV_LORA)
        past_kpe = cache_kpe[l][page_table].reshape(DEC_BATCH, PAST_LEN, QK_ROPE)
        keys_ckv = jnp.concatenate([past_ckv, ckv], axis=1)
        keys_kpe = jnp.concatenate([past_kpe, kpe], axis=1)
        o_lat = mla_attend(q_lat, q_pe, keys_ckv, keys_kpe, pos_s, k_pos_s)
        u_pad = jnp.concatenate([state_conv[l].astype(u.dtype), u], axis=1)
        y_conv = short_conv(u_pad, w_conv[l])
        xs = xs + branch_output(o_lat, g_mla, y_conv, b_gate, g_conv, w_ukv[l], w_out[l], g_post[l])
        ckv_s_l.append(ckv)
        kpe_s_l.append(kpe)
        conv_s_l.append(u_pad[:, -(CONV_W - 1):])
    new_ckv_prompt = jnp.stack(ckv_p_l)
    new_kpe_prompt = jnp.stack(kpe_p_l)
    new_conv_prompt = jnp.stack(conv_p_l)
    new_ckv_sample = jnp.stack(ckv_s_l)
    new_kpe_sample = jnp.stack(kpe_s_l)
    new_conv_sample = jnp.stack(conv_s_l)
    return (xp, xs, new_ckv_prompt, new_kpe_prompt, new_conv_prompt, new_ckv_sample, new_kpe_sample, new_conv_sample)
```

```cpp
#include <hip/hip_runtime.h>
#include <cstdio>
#include <cstdint>

#define LAS __attribute__((address_space(3)))
typedef unsigned short bf16_t;
typedef short bf16x8 __attribute__((ext_vector_type(8)));
typedef short v4i16_t __attribute__((ext_vector_type(4)));
typedef float f32x4 __attribute__((ext_vector_type(4)));
typedef float f32x2 __attribute__((ext_vector_type(2)));
typedef float f32x16 __attribute__((ext_vector_type(16)));
typedef unsigned u32x4 __attribute__((ext_vector_type(4)));
typedef unsigned u32x2 __attribute__((ext_vector_type(2)));
typedef __bf16 bf16x2_t __attribute__((ext_vector_type(2)));

#ifndef MK_N_LAUNCHES
#define MK_N_LAUNCHES 6
#endif
constexpr int N_PHASES = 6;

constexpr int DM = 1024, SEQ = 2048, MP = 16384, NS = 128, MTOT = 16640, DIN = 3232, NZ = 3328;
constexpr int QL = 384, KVL = 256, NQ = 768, NKV = 1024;
constexpr float EPS = 1e-6f;
constexpr float QSCALE = 0.14724444602590306f;
constexpr size_t O_YP = 0, O_YS = 16777216, O_CKVP = 16908288, O_KPEP = 21102592, O_CONVP = 21626880, O_CKVS = 21635072, O_KPES = 21667840, O_CONVS = 21671936;
constexpr size_t MiB = 1u << 20;
constexpr size_t WS_CTL = 0, CTL_BYTES = 65536;
constexpr size_t WS_ROPE = 65536;
constexpr size_t WS_WIN = 1 * MiB, WS_WUQ = 8 * MiB, WS_WUKV = 9 * MiB, WS_WOUT = 10 * MiB, WS_WUK = 12 * MiB;
constexpr size_t WS_SSQQ = 13 * MiB, WS_SSQT = 14 * MiB, WS_QS = 15 * MiB, WS_KPES = 15 * MiB + 512 * 1024, WS_PML = 16 * MiB, WS_PO = 17 * MiB;
constexpr size_t WS_XN = 32 * MiB, WS_CQ = 65 * MiB, WS_CKV = 78 * MiB, WS_SG = 87 * MiB, WS_BG = 104 * MiB, WS_U = 121 * MiB;
constexpr size_t WS_Q = 138 * MiB, WS_K = 162 * MiB, WS_V = 186 * MiB, WS_MIX = 202 * MiB, WS_END = 235 * MiB;
constexpr int STAGE_BYTES_ = 131072, XL_OFF = 131072, MISC_OFF = XL_OFF + 4096, LDS_BYTES = 139264;

__device__ __forceinline__ unsigned cvtpk(float lo, float hi) { f32x2 v = {lo, hi}; bf16x2_t b = __builtin_convertvector(v, bf16x2_t); return __builtin_bit_cast(unsigned, b); }
__device__ __forceinline__ float bf2f(unsigned short b) { return __uint_as_float(((unsigned)b) << 16); }
__device__ __forceinline__ float bflo(unsigned w) { return __uint_as_float(w << 16); }
__device__ __forceinline__ float bfhi(unsigned w) { return __uint_as_float(w & 0xffff0000u); }
__device__ __forceinline__ float fexp2(float x) { return __builtin_amdgcn_exp2f(x); }
__device__ __forceinline__ float silu(float x) { return x * __builtin_amdgcn_rcpf(1.0f + fexp2(-1.4426950408889634f * x)); }
__device__ __forceinline__ int crow(int r, int hi) { return (r & 3) + 8 * (r >> 2) + 4 * hi; }

namespace pg8 {
constexpr int BM = 256, BK = 64, HALF = 128, HTB = HALF * BK * 2, STAGE_BYTES = 8 * HTB, NXCD = 8, WGM = 8;
__host__ __device__ __forceinline__ int lds_byte(int r, int c) { const int st = (r >> 4) * 2 + (c >> 5), rr = r & 15, cc = c & 31, ob = rr * 64 + cc * 2; return st * 1024 + (ob ^ (((ob >> 9) & 1) << 5)); }
__host__ __device__ __forceinline__ void stage_rc(int b, int& R, int& C) { const int st = b / 1024, sb = b % 1024, swz = sb ^ (((sb >> 9) & 1) << 5); R = (st >> 1) * 16 + swz / 64; C = (st & 1) * 32 + (swz % 64) / 2; }
__host__ __device__ __forceinline__ int perm32(int rho) { const int n = rho >> 4, i = rho & 15; return 8 * (i >> 2) + 4 * n + (i & 3); }
struct Unit { int pm, pn; };
struct Gemm { const bf16_t* A; const bf16_t* Bt; int M, N, K; };
struct StaticOrder {
    int nM, nN, nwg, G, c;
    __host__ __device__ void init(int M, int N, int G_, int c_) { nM = M / BM; nN = N / BM; nwg = nM * nN; G = G_; c = c_; }
    __host__ __device__ bool next(int i, Unit& u) const {
        const long L = (long)i * G + c; if (L >= nwg) return false;
        int wgid = (int)L; { const int q = nwg / NXCD, r = nwg % NXCD, xcd = wgid % NXCD, off = wgid / NXCD; wgid = (xcd < r ? xcd * (q + 1) : r * (q + 1) + (xcd - r) * q) + off; }
        const int nig = WGM * nN, gid = wgid / nig, fm = gid * WGM, gsz = (nM - fm) < WGM ? (nM - fm) : WGM;
        u.pm = fm + ((wgid % nig) % gsz); u.pn = (wgid % nig) / gsz; return true;
    }
    __device__ __forceinline__ void a_ready(const Unit&) const {}
    __device__ __forceinline__ void done(const Unit&) const {}
};

template <class Epi, class Sched, bool ALIGN_EPI = false, bool SP2 = false>
__device__ __forceinline__ void gemm_phase(LAS unsigned char* lds, const Gemm g, const Sched& S, const Epi& E) {
    int tid_ = threadIdx.x; asm volatile("" : "+v"(tid_));
    const int tid = tid_, wid = __builtin_amdgcn_readfirstlane(tid >> 6), lane = tid & 63, wr = wid >> 2, wc = wid & 3, fr = lane & 15, fq = lane >> 4;
    const int K = g.K, nt = K / BK;
    unsigned voffA[2], voffB[2];
#pragma unroll
    for (int i = 0; i < 2; ++i) { int R, C; stage_rc(tid * 16 + i * 8192, R, C); const int Rb = Epi::PERM ? ((R & ~31) + perm32(R & 31)) : R;
        voffA[i] = (unsigned)(R * K + C) * 2u; voffB[i] = (unsigned)(Rb * K + C) * 2u; }
    const size_t kstep = (size_t)(BK * 2);
    const size_t hstep = (size_t)HALF * K * 2;
    const size_t tstep = 2 * hstep;
    const unsigned ldsw = (unsigned)wid * 1024u;
    const int aoff = lds_byte(wr * 64 + fr, fq * 8), boff = lds_byte(wc * 32 + fr, fq * 8);
#define PG8_SA(b, h) (((b) * 2 + (h)) * HTB)
#define PG8_SB(b, h) ((4 + (b) * 2 + (h)) * HTB)
#define PG8_STAGE(bufoff, gbase, voff) do { _Pragma("unroll") for (int _i = 0; _i < 2; ++_i) \
        __builtin_amdgcn_global_load_lds((const unsigned*)((const char*)(gbase) + (voff)[_i]), (LAS unsigned*)(lds + (bufoff) + ldsw + _i * 8192), 16, 0, 0); } while (0)
#define PG8_LDA(dst, b, h) do { _Pragma("unroll") for (int m = 0; m < 4; ++m) _Pragma("unroll") for (int k = 0; k < 2; ++k) dst[m][k] = *(const LAS bf16x8*)(lds + PG8_SA(b, h) + aoff + m * 2048 + k * 1024); } while (0)
#define PG8_LDB(dst, b, h) do { _Pragma("unroll") for (int n = 0; n < 2; ++n) _Pragma("unroll") for (int k = 0; k < 2; ++k) dst[n][k] = *(const LAS bf16x8*)(lds + PG8_SB(b, h) + boff + n * 2048 + k * 1024); } while (0)
#define PG8_MMA(ai, bj, At, Bt) do { __builtin_amdgcn_s_setprio(1); _Pragma("unroll") for (int m = 0; m < 4; ++m) _Pragma("unroll") for (int n = 0; n < 2; ++n) _Pragma("unroll") for (int k = 0; k < 2; ++k) \
        acc[ai][bj][m][n] = __builtin_amdgcn_mfma_f32_16x16x32_bf16(Bt[n][k], At[m][k], acc[ai][bj][m][n], 0, 0, 0); __builtin_amdgcn_s_setprio(0); } while (0)
#define PG8_WAIT_V(n) asm volatile("s_waitcnt vmcnt(" #n ")" ::: "memory")
#define PG8_WAIT_L(n) asm volatile("s_waitcnt lgkmcnt(" #n ")" ::: "memory")
#define PG8_BAR __builtin_amdgcn_s_barrier()
#define PG8_SCHED __builtin_amdgcn_sched_barrier(0)
    Unit cur, nxt; int ui = 0;
    if (!S.next(0, cur)) return;
    f32x4 acc[2][2][4][2];
#pragma unroll
    for (int a = 0; a < 2; ++a)
#pragma unroll
        for (int b = 0; b < 2; ++b)
#pragma unroll
            for (int m = 0; m < 4; ++m)
#pragma unroll
                for (int n = 0; n < 2; ++n) acc[a][b][m][n] = (f32x4){0.f, 0.f, 0.f, 0.f};
    bf16x8 At[4][2], B0[2][2], B1[2][2];
    const char* cA = (const char*)g.A + (size_t)cur.pm * tstep; const char* cB = (const char*)g.Bt + (size_t)cur.pn * tstep;
    S.a_ready(cur);
    if constexpr (SP2) {
        PG8_STAGE(PG8_SB(0, 0), cB, voffB); PG8_STAGE(PG8_SB(0, 1), cB + hstep, voffB); PG8_STAGE(PG8_SA(0, 0), cA, voffA); PG8_STAGE(PG8_SA(0, 1), cA + hstep, voffA);
        if (wr == 1) PG8_BAR;
        PG8_WAIT_V(2); PG8_BAR;
        PG8_STAGE(PG8_SB(1, 0), cB + kstep, voffB); PG8_STAGE(PG8_SA(1, 0), cA + kstep, voffA); PG8_STAGE(PG8_SB(1, 1), cB + hstep + kstep, voffB);
        PG8_WAIT_V(6); PG8_BAR;
    } else {
        PG8_STAGE(PG8_SB(0, 0), cB, voffB); PG8_STAGE(PG8_SA(0, 0), cA, voffA); PG8_STAGE(PG8_SB(0, 1), cB + hstep, voffB); PG8_STAGE(PG8_SA(0, 1), cA + hstep, voffA);
        if (wr == 1) PG8_BAR;
        PG8_WAIT_V(4); PG8_BAR;
        PG8_STAGE(PG8_SB(1, 0), cB + kstep, voffB); PG8_STAGE(PG8_SA(1, 0), cA + kstep, voffA); PG8_STAGE(PG8_SB(1, 1), cB + hstep + kstep, voffB);
        PG8_WAIT_V(6); PG8_BAR;
    }
    for (;;) {
        const bool has_next = S.next(ui + 1, nxt);
        const char* nA = has_next ? (const char*)g.A + (size_t)nxt.pm * tstep : cA; const char* nB = has_next ? (const char*)g.Bt + (size_t)nxt.pn * tstep : cB;
        for (int t = 0; t < nt; t += 2) {
            const bool last = (t == nt - 2);
            const char* a1 = cA + (size_t)(t + 1) * kstep;
            const char* a2 = last ? nA : cA + (size_t)(t + 2) * kstep; const char* b2 = last ? nB : cB + (size_t)(t + 2) * kstep;
            const char* a3 = a2 + kstep; const char* b3 = b2 + kstep;
            if (last && has_next) S.a_ready(nxt);
            if constexpr (SP2) {
            PG8_LDB(B0, 0, 0); PG8_LDB(B1, 0, 1); PG8_SCHED; PG8_LDA(At, 0, 0); PG8_STAGE(PG8_SA(1, 1), a1 + hstep, voffA);
            PG8_WAIT_V(8); PG8_WAIT_L(0); PG8_BAR; PG8_MMA(0, 0, At, B0); PG8_MMA(0, 1, At, B1); PG8_BAR; PG8_SCHED;
            PG8_LDA(At, 0, 1); PG8_STAGE(PG8_SB(0, 0), b2, voffB); PG8_STAGE(PG8_SB(0, 1), b2 + hstep, voffB); PG8_STAGE(PG8_SA(0, 0), a2, voffA);
            PG8_WAIT_V(8); PG8_WAIT_L(0); PG8_BAR; PG8_MMA(1, 0, At, B0); PG8_MMA(1, 1, At, B1); PG8_BAR; PG8_SCHED;
            PG8_LDB(B0, 1, 0); PG8_LDB(B1, 1, 1); PG8_SCHED; PG8_LDA(At, 1, 0); PG8_STAGE(PG8_SA(0, 1), a2 + hstep, voffA);
            PG8_WAIT_V(8); PG8_WAIT_L(0); PG8_BAR; PG8_MMA(0, 0, At, B0); PG8_MMA(0, 1, At, B1); PG8_BAR; PG8_SCHED;
            PG8_LDA(At, 1, 1); PG8_STAGE(PG8_SB(1, 0), b3, voffB); PG8_STAGE(PG8_SB(1, 1), b3 + hstep, voffB); PG8_STAGE(PG8_SA(1, 0), a3, voffA);
            PG8_WAIT_V(8); PG8_WAIT_L(0); PG8_BAR; PG8_MMA(1, 0, At, B0); PG8_MMA(1, 1, At, B1); PG8_BAR; PG8_SCHED;
            } else {
            PG8_LDB(B0, 0, 0); PG8_SCHED; PG8_LDA(At, 0, 0); PG8_STAGE(PG8_SA(1, 1), a1 + hstep, voffA);
            PG8_WAIT_L(8); PG8_BAR; PG8_WAIT_L(0); PG8_MMA(0, 0, At, B0); PG8_BAR; PG8_SCHED;
            PG8_LDB(B1, 0, 1); PG8_STAGE(PG8_SB(0, 0), b2, voffB);
            PG8_BAR; PG8_WAIT_L(0); PG8_MMA(0, 1, At, B1); PG8_BAR;
            PG8_LDA(At, 0, 1); PG8_STAGE(PG8_SA(0, 0), a2, voffA);
            PG8_BAR; PG8_WAIT_L(0); PG8_MMA(1, 0, At, B0); PG8_BAR; PG8_SCHED;
            PG8_STAGE(PG8_SB(0, 1), b2 + hstep, voffB);
            PG8_WAIT_V(6); PG8_BAR; PG8_MMA(1, 1, At, B1); PG8_BAR;
            PG8_LDB(B0, 1, 0); PG8_SCHED; PG8_LDA(At, 1, 0); PG8_STAGE(PG8_SA(0, 1), a2 + hstep, voffA);
            PG8_WAIT_L(8); PG8_BAR; PG8_WAIT_L(0); PG8_MMA(0, 0, At, B0); PG8_BAR; PG8_SCHED;
            PG8_LDB(B1, 1, 1); PG8_STAGE(PG8_SB(1, 0), b3, voffB);
            PG8_BAR; PG8_WAIT_L(0); PG8_MMA(0, 1, At, B1); PG8_BAR;
            PG8_LDA(At, 1, 1); PG8_STAGE(PG8_SA(1, 0), a3, voffA);
            PG8_BAR; PG8_WAIT_L(0); PG8_MMA(1, 0, At, B0); PG8_BAR; PG8_SCHED;
            PG8_STAGE(PG8_SB(1, 1), b3 + hstep, voffB);
            PG8_WAIT_V(6); PG8_BAR; PG8_MMA(1, 1, At, B1); PG8_BAR;
            }
        }
        if constexpr (ALIGN_EPI) { if (wr == 0) PG8_BAR; }
        E(acc, cur, wr, wc, fr, fq);
        if (!has_next) break;
#pragma unroll
        for (int a = 0; a < 2; ++a)
#pragma unroll
            for (int b = 0; b < 2; ++b)
#pragma unroll
                for (int m = 0; m < 4; ++m)
#pragma unroll
                    for (int n = 0; n < 2; ++n) acc[a][b][m][n] = (f32x4){0.f, 0.f, 0.f, 0.f};
        cur = nxt; cA = nA; cB = nB; ++ui;
        if constexpr (ALIGN_EPI) { if (wr == 1) PG8_BAR; }
    }
    PG8_WAIT_V(0);
    if constexpr (!ALIGN_EPI) { if (wr == 0) PG8_BAR; }
    PG8_BAR;
#undef PG8_SA
#undef PG8_SB
#undef PG8_STAGE
#undef PG8_LDA
#undef PG8_LDB
#undef PG8_MMA
#undef PG8_WAIT_V
#undef PG8_WAIT_L
#undef PG8_BAR
#undef PG8_SCHED
}
}

#define XB_TMO      128
#define XB_XCNT(j)  (256  + 64 * (j))
#define XB_XSUB(j)  (1280 + 64 * (j))
#define XB_XGEN(j)  (2304 + 64 * (j))
#define XB_TOP      3328
#define XB_TOPGEN   3392
#define XCD_BAR_WORDS 3456
#define XB_SPIN_CAP (1u << 18)
__device__ __forceinline__ unsigned xb_ld(unsigned* p)              { return __hip_atomic_load(p, __ATOMIC_RELAXED, __HIP_MEMORY_SCOPE_AGENT); }
__device__ __forceinline__ unsigned xb_add(unsigned* p, unsigned v) { return __hip_atomic_fetch_add(p, v, __ATOMIC_RELAXED, __HIP_MEMORY_SCOPE_AGENT); }
__device__ __forceinline__ unsigned xb_xcc_id() { return (unsigned)__builtin_amdgcn_s_getreg((3 << 11) | 20) & 0xFu; }
#define XB_SPIN(cond, bar) do { unsigned _sp = 0; while (cond) { __builtin_amdgcn_s_sleep(1); \
    if ((++_sp & 255u) == 0u) { if (xb_ld(&(bar)[XB_TMO])) break; if (_sp > XB_SPIN_CAP) { atomicAdd(&(bar)[XB_TMO], 1u); break; } } } } while (0)
struct XcdBarrier { unsigned* bar; unsigned x; volatile LAS unsigned* st; };
__device__ __forceinline__ XcdBarrier xcd_barrier_post(unsigned* bar, volatile LAS unsigned* st) {
    XcdBarrier b; b.bar = bar; b.x = xb_xcc_id(); b.st = st;
    if (threadIdx.x == 0) (void)xb_add(&bar[XB_XCNT(b.x)], 1u);
    return b;
}
__device__ __forceinline__ void xcd_barrier_complete(unsigned* bar, unsigned x, unsigned& nloc, unsigned& nx) {
    const unsigned G = gridDim.x * gridDim.y * gridDim.z;
    unsigned sum, cnt, mine, sp = 0u;
    for (;;) {
        sum = 0u; cnt = 0u; mine = 0u;
#pragma unroll
        for (unsigned j = 0; j < 16; ++j) { const unsigned c = xb_ld(&bar[XB_XCNT(j)]); sum += c; cnt += (c > 0u) ? 1u : 0u; mine = (j == x) ? c : mine; }
        if (sum == G) break;
        __builtin_amdgcn_s_sleep(1);
        if ((++sp & 255u) == 0u) { if (xb_ld(&bar[XB_TMO])) break; if (sp > XB_SPIN_CAP) { atomicAdd(&bar[XB_TMO], 1u); break; } }
    }
    nloc = mine > 0u ? mine : 1u; nx = cnt > 0u ? cnt : 1u;
}
__device__ __forceinline__ void xcd_barrier(const XcdBarrier& b) {
    asm volatile("s_waitcnt vmcnt(0)" ::: "memory");
    __syncthreads();
    if (threadIdx.x == 0) {
        unsigned* bar = b.bar;
        __builtin_amdgcn_s_waitcnt(0);
        unsigned nloc = b.st[0], nx = b.st[1];
        if (nloc == 0u) { xcd_barrier_complete(bar, b.x, nloc, nx); b.st[0] = nloc; b.st[1] = nx; }
        const unsigned old = xb_add(&bar[XB_XSUB(b.x)], 1u);
        const unsigned gen = old / nloc;
        if (old + 1u == (gen + 1u) * nloc) {
            __builtin_amdgcn_fence(__ATOMIC_RELEASE, "agent");
            asm volatile("s_waitcnt vmcnt(0)" ::: "memory");
            const unsigned og = xb_add(&bar[XB_TOP], 1u);
            const unsigned tg = og / nx;
            if (og + 1u == (tg + 1u) * nx) xb_add(&bar[XB_TOPGEN], 1u);
            else XB_SPIN(xb_ld(&bar[XB_TOPGEN]) == tg, bar);
            __builtin_amdgcn_fence(__ATOMIC_ACQUIRE, "agent");
            xb_add(&bar[XB_XGEN(b.x)], 1u);
            asm volatile("s_waitcnt vmcnt(0)" ::: "memory");
        } else {
            XB_SPIN(xb_ld(&bar[XB_XGEN(b.x)]) == gen, bar);
            __builtin_amdgcn_fence(__ATOMIC_ACQUIRE, "agent");
            asm volatile("s_waitcnt vmcnt(0)" ::: "memory");
        }
    }
    __syncthreads();
}

struct Params { const void* in[15]; float* out; unsigned char* ws; int ph_lo, ph_hi; };
struct Frame {
    LAS unsigned char* lds; int tid, lane, wave, vcu, G;
    const float *xp, *xs, *cckv, *ckpe, *sconv, *gpre, *win, *gq, *wuq, *gkv, *wukv, *wconv, *wout, *gpost; const int* pt;
    float* out;
    f32x2* rope; bf16_t *WIN, *WUQ, *WUKV, *WOUT, *WUK; float *SSQQ, *SSQT; bf16_t *QS, *KPES; float *PML, *PO;
    bf16_t *XN, *CQ, *CKV, *SG, *BG, *U, *Q, *K, *V, *MIX;
};
#define LDS_WAIT() asm volatile("s_waitcnt lgkmcnt(0)" ::: "memory")
#define WG_BAR() do { asm volatile("s_waitcnt lgkmcnt(0)" ::: "memory"); __builtin_amdgcn_s_barrier(); asm volatile("" ::: "memory"); } while (0)

__device__ __forceinline__ int fresh_lane() { int l; asm volatile("v_mbcnt_lo_u32_b32 %0, -1, 0\n\tv_mbcnt_hi_u32_b32 %0, -1, %0" : "=v"(l)); return l; }
__device__ __forceinline__ int rope_idx(int r) { return r < MP ? (r & (SEQ - 1)) : SEQ + ((r - MP) & 3); }

struct EpiZ {
    static constexpr bool PERM = false;
    bf16_t *CQ, *CKV, *SG, *BG, *U, *Kb, *KPES; float* SSQQ; const float* gkv; const f32x2* rope; float* out; LAS float* red;
    __device__ __forceinline__ void operator()(const f32x4 (&acc)[2][2][4][2], const pg8::Unit& u, int wr, int wc, int fr_, int fq_) const {
        const int lane_ = fresh_lane(), fr = lane_ & 15, fq = lane_ >> 4; (void)fr_; (void)fq_;
        const int row0 = u.pm * 256 + wr * 64 + fr, col8 = wc * 32 + 8 * fq, t = u.pn;
        if (t <= 1) {
#pragma unroll
            for (int ai = 0; ai < 2; ++ai)
#pragma unroll
                for (int m = 0; m < 4; ++m) {
                    const int r = row0 + ai * 128 + m * 16; float ss = 0.f;
#pragma unroll
                    for (int bj = 0; bj < 2; ++bj) {
                        if (t == 1 && bj == 1) break;
                        const f32x4 v0 = acc[ai][bj][m][0], v1 = acc[ai][bj][m][1];
                        ss += (v0[0] * v0[0] + v0[1] * v0[1]) + (v0[2] * v0[2] + v0[3] * v0[3]) + (v1[0] * v1[0] + v1[1] * v1[1]) + (v1[2] * v1[2] + v1[3] * v1[3]);
                        u32x4 w; w.x = cvtpk(v0[0], v0[1]); w.y = cvtpk(v0[2], v0[3]); w.z = cvtpk(v1[0], v1[1]); w.w = cvtpk(v1[2], v1[3]);
                        *(u32x4*)(CQ + (size_t)r * QL + t * 256 + bj * 128 + col8) = w;
                    }
                    ss += __shfl_xor(ss, 16); ss += __shfl_xor(ss, 32);
                    if (fq == 0) SSQQ[(size_t)r * 8 + t * 4 + wc] = ss;
                    if (t == 1 && wc == 0) {
                        const f32x4 x1 = acc[ai][1][m][0], x2 = acc[ai][1][m][1];
                        const f32x4 cs0 = *(const f32x4*)(rope + (size_t)rope_idx(r) * 16 + 4 * fq), cs1 = *(const f32x4*)(rope + (size_t)rope_idx(r) * 16 + 4 * fq + 2);
                        f32x4 o1, o2;
                        o1[0] = x1[0] * cs0[0] - x2[0] * cs0[1]; o2[0] = x2[0] * cs0[0] + x1[0] * cs0[1];
                        o1[1] = x1[1] * cs0[2] - x2[1] * cs0[3]; o2[1] = x2[1] * cs0[2] + x1[1] * cs0[3];
                        o1[2] = x1[2] * cs1[0] - x2[2] * cs1[1]; o2[2] = x2[2] * cs1[0] + x1[2] * cs1[1];
                        o1[3] = x1[3] * cs1[2] - x2[3] * cs1[3]; o2[3] = x2[3] * cs1[2] + x1[3] * cs1[3];
                        u32x2 p1, p2; p1.x = cvtpk(o1[0], o1[1]); p1.y = cvtpk(o1[2], o1[3]); p2.x = cvtpk(o2[0], o2[1]); p2.y = cvtpk(o2[2], o2[3]);
                        if (r < MP) {
                            *(f32x4*)(out + O_KPEP + (size_t)r * 32 + 4 * fq) = o1; *(f32x4*)(out + O_KPEP + (size_t)r * 32 + 16 + 4 * fq) = o2;
                            const int b = r >> 11, tt = r & (SEQ - 1);
#pragma unroll
                            for (int h = 0; h < 8; ++h) { bf16_t* kp = Kb + ((size_t)(b * 8 + h) * SEQ + tt) * 96 + 64 + 4 * fq; *(u32x2*)kp = p1; *(u32x2*)(kp + 16) = p2; }
                        } else if (r < MP + NS) {
                            const int rs = r - MP;
                            *(f32x4*)(out + O_KPES + (size_t)rs * 32 + 4 * fq) = o1; *(f32x4*)(out + O_KPES + (size_t)rs * 32 + 16 + 4 * fq) = o2;
                            *(u32x2*)(KPES + rs * 32 + 4 * fq) = p1; *(u32x2*)(KPES + rs * 32 + 16 + 4 * fq) = p2;
                        }
                    }
                }
        } else if (t == 2) {
            float ssv[2][4];
#pragma unroll
            for (int ai = 0; ai < 2; ++ai)
#pragma unroll
                for (int m = 0; m < 4; ++m) {
                    float ss = 0.f;
#pragma unroll
                    for (int bj = 0; bj < 2; ++bj)
#pragma unroll
                        for (int n = 0; n < 2; ++n) { const f32x4 v = acc[ai][bj][m][n]; ss += (v[0] * v[0] + v[1] * v[1]) + (v[2] * v[2] + v[3] * v[3]); }
                    ss += __shfl_xor(ss, 16); ss += __shfl_xor(ss, 32);
                    if (fq == 0) red[(wr * 4 + wc) * 128 + ai * 64 + m * 16 + fr] = ss;
                }
            WG_BAR();
            f32x4 gv[2][2];
#pragma unroll
            for (int bj = 0; bj < 2; ++bj)
#pragma unroll
                for (int n = 0; n < 2; ++n) gv[bj][n] = *(const f32x4*)(gkv + bj * 128 + col8 + 4 * n);
#pragma unroll
            for (int ai = 0; ai < 2; ++ai)
#pragma unroll
                for (int m = 0; m < 4; ++m) {
                    const int rl = ai * 64 + m * 16 + fr;
                    const float tot = (red[(wr * 4 + 0) * 128 + rl] + red[(wr * 4 + 1) * 128 + rl]) + (red[(wr * 4 + 2) * 128 + rl] + red[(wr * 4 + 3) * 128 + rl]);
                    ssv[ai][m] = rsqrtf(tot * (1.0f / 256.0f) + EPS);
                }
#pragma unroll
            for (int ai = 0; ai < 2; ++ai)
#pragma unroll
                for (int m = 0; m < 4; ++m) {
                    const int r = row0 + ai * 128 + m * 16; const float inv = ssv[ai][m];
                    float* orow = r < MP ? out + O_CKVP + (size_t)r * 256 : out + O_CKVS + (size_t)(r - MP) * 256;
#pragma unroll
                    for (int bj = 0; bj < 2; ++bj) {
                        const f32x4 v0 = acc[ai][bj][m][0] * inv * gv[bj][0], v1 = acc[ai][bj][m][1] * inv * gv[bj][1];
                        if (r < MP + NS) { *(f32x4*)(orow + bj * 128 + col8) = v0; *(f32x4*)(orow + bj * 128 + col8 + 4) = v1; }
                        u32x4 w; w.x = cvtpk(v0[0], v0[1]); w.y = cvtpk(v0[2], v0[3]); w.z = cvtpk(v1[0], v1[1]); w.w = cvtpk(v1[2], v1[3]);
                        *(u32x4*)(CKV + (size_t)r * KVL + bj * 128 + col8) = w;
                    }
                }
        } else if (t <= 4) {
#pragma unroll
            for (int ai = 0; ai < 2; ++ai)
#pragma unroll
                for (int m = 0; m < 4; ++m) {
                    const int r = row0 + ai * 128 + m * 16;
#pragma unroll
                    for (int bj = 0; bj < 2; ++bj) {
                        const f32x4 v0 = acc[ai][bj][m][0], v1 = acc[ai][bj][m][1];
                        u32x4 w; w.x = cvtpk(silu(v0[0]), silu(v0[1])); w.y = cvtpk(silu(v0[2]), silu(v0[3])); w.z = cvtpk(silu(v1[0]), silu(v1[1])); w.w = cvtpk(silu(v1[2]), silu(v1[3]));
                        *(u32x4*)(SG + (size_t)r * 512 + (t - 3) * 256 + bj * 128 + col8) = w;
                    }
                }
        } else if (t <= 8) {
            const int j = t - 5;
#pragma unroll
            for (int ai = 0; ai < 2; ++ai)
#pragma unroll
                for (int m = 0; m < 4; ++m) {
                    const int r = row0 + ai * 128 + m * 16;
                    const f32x4 b0 = acc[ai][0][m][0], b1 = acc[ai][0][m][1], g0 = acc[ai][1][m][0], g1 = acc[ai][1][m][1];
                    u32x4 w; w.x = cvtpk(b0[0] * silu(g0[0]), b0[1] * silu(g0[1])); w.y = cvtpk(b0[2] * silu(g0[2]), b0[3] * silu(g0[3]));
                    w.z = cvtpk(b1[0] * silu(g1[0]), b1[1] * silu(g1[1])); w.w = cvtpk(b1[2] * silu(g1[2]), b1[3] * silu(g1[3]));
                    *(u32x4*)(BG + (size_t)r * 512 + j * 128 + col8) = w;
                }
        } else {
            const int j = t - 9;
#pragma unroll
            for (int ai = 0; ai < 2; ++ai)
#pragma unroll
                for (int m = 0; m < 4; ++m) {
                    const int r = row0 + ai * 128 + m * 16;
                    const f32x4 u0 = acc[ai][0][m][0] * acc[ai][1][m][0], u1 = acc[ai][0][m][1] * acc[ai][1][m][1];
                    u32x4 w; w.x = cvtpk(u0[0], u0[1]); w.y = cvtpk(u0[2], u0[3]); w.z = cvtpk(u1[0], u1[1]); w.w = cvtpk(u1[2], u1[3]);
                    *(u32x4*)(U + (size_t)r * 512 + j * 128 + col8) = w;
                    if (r < MP) { const int tt = r & (SEQ - 1); if (tt >= SEQ - 2) { float* o = out + O_CONVP + ((size_t)(r >> 11) * 2 + (tt - (SEQ - 2))) * 512 + j * 128 + col8; *(f32x4*)o = u0; *(f32x4*)(o + 4) = u1; } }
                    else if (r < MP + NS) { const int rs = r - MP, tok = rs & 3; if (tok >= 2) { float* o = out + O_CONVS + ((size_t)(rs >> 2) * 2 + (tok - 2)) * 512 + j * 128 + col8; *(f32x4*)o = u0; *(f32x4*)(o + 4) = u1; } }
                }
        }
    }
};

struct EpiQ {
    static constexpr bool PERM = false;
    bf16_t *Q, *QS; const float* SSQQ; const f32x2* rope;
    __device__ __forceinline__ void operator()(const f32x4 (&acc)[2][2][4][2], const pg8::Unit& u, int wr, int wc, int fr_, int fq_) const {
        const int lane_ = fresh_lane(), fr = lane_ & 15, fq = lane_ >> 4; (void)fr_; (void)fq_;
        const int row0 = u.pm * 256 + wr * 64 + fr, col8 = wc * 32 + 8 * fq, t = u.pn;
#pragma unroll
        for (int ai = 0; ai < 2; ++ai)
#pragma unroll
            for (int m = 0; m < 4; ++m) {
                const int r = row0 + ai * 128 + m * 16;
                const f32x4 s0 = *(const f32x4*)(SSQQ + (size_t)r * 8), s1 = *(const f32x4*)(SSQQ + (size_t)r * 8 + 4);
                const float sc = rsqrtf(((s0[0] + s0[1]) + (s0[2] + s0[3]) + (s1[0] + s1[1]) + (s1[2] + s1[3])) * (1.0f / 384.0f) + EPS) * QSCALE;
                const bool isp = r < MP, iss = !isp && r < MP + NS;
                const int b = r >> 11, tt = r & (SEQ - 1), rs = r - MP;
                if (t < 2) {
#pragma unroll
                    for (int bj = 0; bj < 2; ++bj) {
                        const int L = t * 256 + bj * 128 + col8, head = L >> 6, d = L & 63;
                        const f32x4 v0 = acc[ai][bj][m][0] * sc, v1 = acc[ai][bj][m][1] * sc;
                        u32x4 w; w.x = cvtpk(v0[0], v0[1]); w.y = cvtpk(v0[2], v0[3]); w.z = cvtpk(v1[0], v1[1]); w.w = cvtpk(v1[2], v1[3]);
                        if (isp) *(u32x4*)(Q + ((size_t)(b * 8 + head) * SEQ + tt) * 96 + d) = w;
                        else if (iss) *(u32x4*)(QS + (size_t)rs * NQ + head * 96 + d) = w;
                    }
                } else {
                    const f32x4 cs0 = *(const f32x4*)(rope + (size_t)rope_idx(r) * 16 + 4 * fq), cs1 = *(const f32x4*)(rope + (size_t)rope_idx(r) * 16 + 4 * fq + 2);
#pragma unroll
                    for (int bj = 0; bj < 2; ++bj) {
                        const int head = 4 * bj + wc;
                        const f32x4 x1 = acc[ai][bj][m][0] * sc, x2 = acc[ai][bj][m][1] * sc;
                        f32x4 o1, o2;
                        o1[0] = x1[0] * cs0[0] - x2[0] * cs0[1]; o2[0] = x2[0] * cs0[0] + x1[0] * cs0[1];
                        o1[1] = x1[1] * cs0[2] - x2[1] * cs0[3]; o2[1] = x2[1] * cs0[2] + x1[1] * cs0[3];
                        o1[2] = x1[2] * cs1[0] - x2[2] * cs1[1]; o2[2] = x2[2] * cs1[0] + x1[2] * cs1[1];
                        o1[3] = x1[3] * cs1[2] - x2[3] * cs1[3]; o2[3] = x2[3] * cs1[2] + x1[3] * cs1[3];
                        u32x2 p1, p2; p1.x = cvtpk(o1[0], o1[1]); p1.y = cvtpk(o1[2], o1[3]); p2.x = cvtpk(o2[0], o2[1]); p2.y = cvtpk(o2[2], o2[3]);
                        bf16_t* dst = isp ? Q + ((size_t)(b * 8 + head) * SEQ + tt) * 96 + 64 + 4 * fq : QS + (size_t)rs * NQ + head * 96 + 64 + 4 * fq;
                        if (isp || iss) { *(u32x2*)dst = p1; *(u32x2*)(dst + 16) = p2; }
                    }
                }
                asm volatile("" ::: "memory");
            }
    }
};

struct EpiKV {
    static constexpr bool PERM = false;
    bf16_t *Kb, *Vb;
    __device__ __forceinline__ void operator()(const f32x4 (&acc)[2][2][4][2], const pg8::Unit& u, int wr, int wc, int fr_, int fq_) const {
        const int lane_ = fresh_lane(), fr = lane_ & 15, fq = lane_ >> 4; (void)fr_; (void)fq_;
        const int row0 = u.pm * 256 + wr * 64 + fr, col8 = wc * 32 + 8 * fq;
#pragma unroll
        for (int ai = 0; ai < 2; ++ai)
#pragma unroll
            for (int m = 0; m < 4; ++m) {
                const int r = row0 + ai * 128 + m * 16, b = r >> 11, tt = r & (SEQ - 1);
#pragma unroll
                for (int bj = 0; bj < 2; ++bj) {
                    const int head = 2 * u.pn + bj;
                    const f32x4 v0 = acc[ai][bj][m][0], v1 = acc[ai][bj][m][1];
                    u32x4 w; w.x = cvtpk(v0[0], v0[1]); w.y = cvtpk(v0[2], v0[3]); w.z = cvtpk(v1[0], v1[1]); w.w = cvtpk(v1[2], v1[3]);
                    if (col8 < 64) *(u32x4*)(Kb + ((size_t)(b * 8 + head) * SEQ + tt) * 96 + col8) = w;
                    else *(u32x4*)(Vb + ((size_t)(b * 8 + head) * SEQ + tt) * 64 + col8 - 64) = w;
                }
            }
    }
};

struct EpiOut {
    static constexpr bool PERM = false;
    float* Y; float* SSQT;
    __device__ __forceinline__ void operator()(const f32x4 (&acc)[2][2][4][2], const pg8::Unit& u, int wr, int wc, int fr_, int fq_) const {
        const int lane_ = fresh_lane(), fr = lane_ & 15, fq = lane_ >> 4; (void)fr_; (void)fq_;
        const int row0 = u.pm * 256 + wr * 64 + fr, col0 = u.pn * 256 + wc * 32 + 4 * fq;
#pragma unroll
        for (int ai = 0; ai < 2; ++ai)
#pragma unroll
            for (int m = 0; m < 4; ++m) {
                const int r = row0 + ai * 128 + m * 16; float ss = 0.f;
#pragma unroll
                for (int bj = 0; bj < 2; ++bj)
#pragma unroll
                    for (int n = 0; n < 2; ++n) { const f32x4 v = acc[ai][bj][m][n]; ss += (v[0] * v[0] + v[1] * v[1]) + (v[2] * v[2] + v[3] * v[3]);
                        *(f32x4*)(Y + (size_t)r * DM + col0 + bj * 128 + n * 16) = v; }
                ss += __shfl_xor(ss, 16); ss += __shfl_xor(ss, 32);
                if (fq == 0) SSQT[(size_t)r * 16 + u.pn * 4 + wc] = ss;
            }
    }
};

__device__ __forceinline__ int zmap(int pos) {
    const int tile = pos >> 8, p = pos & 255, g = p >> 5, q = p & 31;
    const bool ropeg = (tile == 1 && g == 4);
    const int L = 32 * g + (ropeg ? q : pg8::perm32(q));
    if (tile == 0) return L;
    if (tile == 1) return L < 128 ? 256 + L : (L < 160 ? 640 + (L - 128) : -1);
    if (tile == 2) return 384 + L;
    if (tile <= 4) return 672 + (tile - 3) * 256 + L;
    if (tile <= 8) { const int j = tile - 5; return L < 128 ? 1184 + 128 * j + L : 2720 + 128 * j + (L - 128); }
    { const int j = tile - 9; return L < 128 ? 1696 + 128 * j + L : 2208 + 128 * j + (L - 128); }
}
__device__ __forceinline__ int qmap(int pos) {
    const int tile = pos >> 8, p = pos & 255, g = p >> 5, q = p & 31;
    if (tile < 2) { const int L = tile * 256 + 32 * g + pg8::perm32(q); return (L >> 6) * 96 + (L & 63); }
    return g * 96 + 64 + q;
}
__device__ __forceinline__ int kvmap(int pos) { return (pos & ~31) + pg8::perm32(pos & 31); }
__device__ __forceinline__ int idmap(int pos) { return pos; }

template <int MAPID>
__device__ __forceinline__ void p0_transpose_item(const float* W, int K, int N, int npos, bf16_t* WT, const float* kgain, LAS float* scr, int item, int lane) {
    const int nblk = npos / 32, kb = item / nblk, nb = item % nblk, k0 = 64 * kb, n0 = 32 * nb;
    const int pos = n0 + (lane & 31);
    const int src = MAPID == 0 ? zmap(pos) : MAPID == 1 ? qmap(pos) : MAPID == 2 ? kvmap(pos) : idmap(pos);
#pragma unroll 8
    for (int i = 0; i < 32; ++i) { const int kk = 2 * i + (lane >> 5); float v = 0.f; if (src >= 0) { v = W[(size_t)(k0 + kk) * N + src]; if (kgain) v *= kgain[k0 + kk]; } scr[kk * 33 + (lane & 31)] = v; }
    LDS_WAIT();
    const int c = lane & 7;
#pragma unroll
    for (int j = 0; j < 4; ++j) { const int n = (lane >> 3) + 8 * j; const LAS float* s = scr + (8 * c) * 33 + n;
        u32x4 o; o.x = cvtpk(s[0 * 33], s[1 * 33]); o.y = cvtpk(s[2 * 33], s[3 * 33]); o.z = cvtpk(s[4 * 33], s[5 * 33]); o.w = cvtpk(s[6 * 33], s[7 * 33]);
        *(u32x4*)(WT + (size_t)(n0 + n) * K + k0 + 8 * c) = o; }
    LDS_WAIT();
}
__device__ __forceinline__ float wave_sum(float v) {
#pragma unroll
    for (int o = 1; o < 64; o <<= 1) v += __shfl_xor(v, o);
    return v;
}
__constant__ float c_invfreq[16] = {1.000000000e+00f, 5.623413324e-01f, 3.162277639e-01f, 1.778279394e-01f, 1.000000015e-01f, 5.623413250e-02f, 3.162277490e-02f, 1.778279431e-02f,
                                    9.999999776e-03f, 5.623413250e-03f, 3.162277630e-03f, 1.778279431e-03f, 1.000000047e-03f, 5.623413017e-04f, 3.162277571e-04f, 1.778279402e-04f};
__device__ __forceinline__ void p0_prep(Frame& F) {
    const int gw = F.vcu * 8 + F.wave, NGW = F.G * 8, lane = F.lane;
    {
        f32x4 g[4];
#pragma unroll
        for (int j = 0; j < 4; ++j) g[j] = *(const f32x4*)(F.gpre + 4 * (64 * j + lane));
        for (int r = gw; r < MTOT; r += NGW) {
            u32x2* orow = (u32x2*)(F.XN + (size_t)r * DM) + lane;
            if (r >= MP + NS) {
#pragma unroll
                for (int j = 0; j < 4; ++j) orow[64 * j] = (u32x2){0u, 0u};
                continue; }
            const float* xr = r < MP ? F.xp + (size_t)r * DM : F.xs + (size_t)(r - MP) * DM;
            f32x4 v[4]; float s = 0.f;
#pragma unroll
            for (int j = 0; j < 4; ++j) { v[j] = *(const f32x4*)(xr + 4 * (64 * j + lane)); s += (v[j][0] * v[j][0] + v[j][1] * v[j][1]) + (v[j][2] * v[j][2] + v[j][3] * v[j][3]); }
            const float inv = rsqrtf(wave_sum(s) * (1.0f / DM) + EPS);
#pragma unroll
            for (int j = 0; j < 4; ++j) { const f32x4 y = v[j] * inv * g[j]; u32x2 w; w.x = cvtpk(y[0], y[1]); w.y = cvtpk(y[2], y[3]); orow[64 * j] = w; }
        }
    }
    {
        LAS float* scr = (LAS float*)(F.lds + F.wave * 8704);
        constexpr int I_Z = 16 * (NZ / 32), I_Q = 6 * (NQ / 32), I_KV = 4 * (NKV / 32), I_O = 16 * (DM / 32);
        for (int it = gw; it < I_Z + I_Q + I_KV + I_O; it += NGW) {
            int r = it;
            if (r < I_Z) { p0_transpose_item<0>(F.win, DM, DIN, NZ, F.WIN, nullptr, scr, r, lane); continue; } r -= I_Z;
            if (r < I_Q) { p0_transpose_item<1>(F.wuq, QL, NQ, NQ, F.WUQ, F.gq, scr, r, lane); continue; } r -= I_Q;
            if (r < I_KV) { p0_transpose_item<2>(F.wukv, KVL, NKV, NKV, F.WUKV, nullptr, scr, r, lane); continue; } r -= I_KV;
            p0_transpose_item<3>(F.wout, DM, DM, DM, F.WOUT, nullptr, scr, r, lane);
        }
    }
    for (int i = gw; i < 8 * 256; i += NGW) { const int h = i >> 8, c = i & 255; F.WUK[(size_t)i * 64 + lane] = (bf16_t)(cvtpk(F.wukv[(size_t)c * NKV + h * 128 + lane], 0.f) & 0xffffu); }
    for (int i = (F.vcu * 512 + F.tid); i < 2052 * 16; i += F.G * 512) {
        const int pi = i >> 4, fi = i & 15; const float pos = (float)(pi < SEQ ? pi : 16384 + (pi - SEQ));
        const float ang = pos * c_invfreq[fi];
        const double rev = (double)ang * 0.15915494309189535; const float fr = (float)(rev - __builtin_rint(rev));
        F.rope[i] = (f32x2){__builtin_amdgcn_cosf(fr), __builtin_amdgcn_sinf(fr)};
    }
}

__device__ __forceinline__ void conv_rows(Frame& F) {
    const int gw = F.vcu * 8 + F.wave, NGW = F.G * 8, lane = F.lane, c0 = 8 * lane;
    f32x4 w[3][2];
#pragma unroll
    for (int k = 0; k < 3; ++k) { w[k][0] = *(const f32x4*)(F.wconv + k * 512 + c0); w[k][1] = *(const f32x4*)(F.wconv + k * 512 + c0 + 4); }
    for (int r = gw; r < MP + NS; r += NGW) {
        const bool samp = r >= MP; const int tt = samp ? ((r - MP) & 3) : (r & (SEQ - 1));
        float y[8];
        { const u32x4 uu = *(const u32x4*)(F.U + (size_t)r * 512 + c0);
          y[0] = w[2][0][0] * bflo(uu.x); y[1] = w[2][0][1] * bfhi(uu.x); y[2] = w[2][0][2] * bflo(uu.y); y[3] = w[2][0][3] * bfhi(uu.y);
          y[4] = w[2][1][0] * bflo(uu.z); y[5] = w[2][1][1] * bfhi(uu.z); y[6] = w[2][1][2] * bflo(uu.w); y[7] = w[2][1][3] * bfhi(uu.w); }
#pragma unroll
        for (int k = 1; k <= 2; ++k) {
            if (tt - k >= 0) { const u32x4 uu = *(const u32x4*)(F.U + (size_t)(r - k) * 512 + c0);
                y[0] += w[2 - k][0][0] * bflo(uu.x); y[1] += w[2 - k][0][1] * bfhi(uu.x); y[2] += w[2 - k][0][2] * bflo(uu.y); y[3] += w[2 - k][0][3] * bfhi(uu.y);
                y[4] += w[2 - k][1][0] * bflo(uu.z); y[5] += w[2 - k][1][1] * bfhi(uu.z); y[6] += w[2 - k][1][2] * bflo(uu.w); y[7] += w[2 - k][1][3] * bfhi(uu.w);
            } else if (samp) { const float* st = F.sconv + ((size_t)((r - MP) >> 2) * 2 + (2 + tt - k)) * 512 + c0; const f32x4 a = *(const f32x4*)st, bq = *(const f32x4*)(st + 4);
                y[0] += w[2 - k][0][0] * a[0]; y[1] += w[2 - k][0][1] * a[1]; y[2] += w[2 - k][0][2] * a[2]; y[3] += w[2 - k][0][3] * a[3];
                y[4] += w[2 - k][1][0] * bq[0]; y[5] += w[2 - k][1][1] * bq[1]; y[6] += w[2 - k][1][2] * bq[2]; y[7] += w[2 - k][1][3] * bq[3]; }
        }
        const u32x4 bg = *(const u32x4*)(F.BG + (size_t)r * 512 + c0);
        u32x4 o; o.x = cvtpk(y[0] * bflo(bg.x), y[1] * bfhi(bg.x)); o.y = cvtpk(y[2] * bflo(bg.y), y[3] * bfhi(bg.y)); o.z = cvtpk(y[4] * bflo(bg.z), y[5] * bfhi(bg.z)); o.w = cvtpk(y[6] * bflo(bg.w), y[7] * bfhi(bg.w));
        *(u32x4*)(F.MIX + (size_t)r * DM + 512 + c0) = o;
    }
}

__device__ __forceinline__ bf16x8 vtr2(const LAS unsigned char* p0, const LAS unsigned char* p1) {
    const v4i16_t a = __builtin_amdgcn_ds_read_tr16_b64_v4i16((LAS v4i16_t*)p0);
    const v4i16_t b = __builtin_amdgcn_ds_read_tr16_b64_v4i16((LAS v4i16_t*)p1);
    return (bf16x8){a[0], a[1], a[2], a[3], b[0], b[1], b[2], b[3]};
}
__device__ __forceinline__ bf16x8 pack8(const f32x16& p, int o) {
    u32x4 w; w.x = cvtpk(p[o + 0], p[o + 1]); w.y = cvtpk(p[o + 2], p[o + 3]); w.z = cvtpk(p[o + 4], p[o + 5]); w.w = cvtpk(p[o + 6], p[o + 7]);
    return __builtin_bit_cast(bf16x8, w);
}
constexpr int AT_KS = 208, AT_KB = 64 * AT_KS  , AT_V0 = 2 * AT_KB  , AT_VB = 8192;
__device__ __forceinline__ void attn_unit(Frame& F, int b, int h, int qb) {
    const int tid = F.tid, lane = F.lane, r32 = lane & 31, hi = lane >> 5, wid = F.wave;
    LAS unsigned char* lds = F.lds;
    const size_t bh = (size_t)(b * 8 + h) * SEQ;
    const bf16_t* Qh = F.Q + bh * 96; const unsigned char* Kh = (const unsigned char*)(F.K + bh * 96); const unsigned char* Vh = (const unsigned char*)(F.V + bh * 64);
    const int q0 = qb * 256, qrel = 32 * wid + r32, NT = 4 * (qb + 1);
    bf16x8 qf[6];
#pragma unroll
    for (int s = 0; s < 6; ++s) qf[s] = *(const bf16x8*)(Qh + (size_t)(q0 + qrel) * 96 + 16 * s + 8 * hi);
    u32x4 kr0, kr1 = (u32x4){0u, 0u, 0u, 0u}, vr;
    const int kc0 = tid, kc1 = tid + 512;
    const int kw0 = (kc0 / 12) * AT_KS + (kc0 % 12) * 16, kw1 = (kc1 / 12) * AT_KS + (kc1 % 12) * 16;
    const int vw = ((tid & 7) >> 2) * 4096 + (tid >> 3) * 64 + (tid & 3) * 16;
#define AT_LOAD(t) do { kr0 = *(const u32x4*)(Kh + (size_t)(t) * 12288 + tid * 16); if (tid < 256) kr1 = *(const u32x4*)(Kh + (size_t)(t) * 12288 + 8192 + tid * 16); vr = *(const u32x4*)(Vh + (size_t)(t) * 8192 + tid * 16); } while (0)
#define AT_WRITE(buf) do { *(LAS u32x4*)(lds + (buf) * AT_KB + kw0) = kr0; if (tid < 256) *(LAS u32x4*)(lds + (buf) * AT_KB + kw1) = kr1; *(LAS u32x4*)(lds + AT_V0 + (buf) * AT_VB + vw) = vr; } while (0)
    AT_LOAD(0); AT_WRITE(0); AT_LOAD(1);
    __syncthreads();
    float m_run = -INFINITY, l_run = 0.f; f32x16 o0 = {}, o1 = {};
    const int vboff = ((lane >> 4) & 1) * 32 + (lane & 3) * 8 + (4 * hi + ((lane & 15) >> 2)) * 64;
    for (int t = 0; t < NT; ++t) {
        const int buf = t & 1, jb = t - (NT - 4);
        const bool skip = jb >= 0 && 64 * jb > 32 * wid + 31;
        if (!skip) {
            const LAS unsigned char* kb = lds + buf * AT_KB + r32 * AT_KS + 16 * hi;
            f32x16 p0 = {}, p1 = {};
#pragma unroll
            for (int s = 0; s < 6; ++s) {
                const bf16x8 a0 = *(const LAS bf16x8*)(kb + 32 * s), a1 = *(const LAS bf16x8*)(kb + 32 * AT_KS + 32 * s);
                p0 = __builtin_amdgcn_mfma_f32_32x32x16_bf16(a0, qf[s], p0, 0, 0, 0);
                p1 = __builtin_amdgcn_mfma_f32_32x32x16_bf16(a1, qf[s], p1, 0, 0, 0);
            }
            if (jb >= 0) {
#pragma unroll
                for (int r = 0; r < 16; ++r) { const int kv = 64 * jb + crow(r, hi); if (kv > qrel) p0[r] = -INFINITY; if (kv + 32 > qrel) p1[r] = -INFINITY; }
            }
            float mx = fmaxf(p0[0], p1[0]);
#pragma unroll
            for (int r = 1; r < 16; ++r) mx = fmaxf(mx, fmaxf(p0[r], p1[r]));
            mx = fmaxf(mx, __shfl_xor(mx, 32));
            const float mn = fmaxf(m_run, mx), alpha = fexp2(m_run - mn);
            float ls = 0.f;
#pragma unroll
            for (int r = 0; r < 16; ++r) { p0[r] = fexp2(p0[r] - mn); p1[r] = fexp2(p1[r] - mn); ls += p0[r] + p1[r]; }
            l_run = l_run * alpha + ls; m_run = mn;
            o0 = o0 * alpha; o1 = o1 * alpha;
            const bf16x8 pa0 = pack8(p0, 0), pa1 = pack8(p0, 8), pa2 = pack8(p1, 0), pa3 = pack8(p1, 8);
            const LAS unsigned char* vb = lds + AT_V0 + buf * AT_VB + vboff;
            o0 = __builtin_amdgcn_mfma_f32_32x32x16_bf16(vtr2(vb, vb + 512), pa0, o0, 0, 0, 0);
            o0 = __builtin_amdgcn_mfma_f32_32x32x16_bf16(vtr2(vb + 1024, vb + 1536), pa1, o0, 0, 0, 0);
            o0 = __builtin_amdgcn_mfma_f32_32x32x16_bf16(vtr2(vb + 2048, vb + 2560), pa2, o0, 0, 0, 0);
            o0 = __builtin_amdgcn_mfma_f32_32x32x16_bf16(vtr2(vb + 3072, vb + 3584), pa3, o0, 0, 0, 0);
            o1 = __builtin_amdgcn_mfma_f32_32x32x16_bf16(vtr2(vb + 4096, vb + 4096 + 512), pa0, o1, 0, 0, 0);
            o1 = __builtin_amdgcn_mfma_f32_32x32x16_bf16(vtr2(vb + 4096 + 1024, vb + 4096 + 1536), pa1, o1, 0, 0, 0);
            o1 = __builtin_amdgcn_mfma_f32_32x32x16_bf16(vtr2(vb + 4096 + 2048, vb + 4096 + 2560), pa2, o1, 0, 0, 0);
            o1 = __builtin_amdgcn_mfma_f32_32x32x16_bf16(vtr2(vb + 4096 + 3072, vb + 4096 + 3584), pa3, o1, 0, 0, 0);
        }
        if (t + 1 < NT) { AT_WRITE((t + 1) & 1); if (t + 2 < NT) AT_LOAD(t + 2); }
        __syncthreads();
    }
#undef AT_LOAD
#undef AT_WRITE
    const float inv = 1.0f / (l_run + __shfl_xor(l_run, 32));
    const size_t row = (size_t)b * SEQ + q0 + qrel;
#pragma unroll
    for (int d0 = 0; d0 < 2; ++d0)
#pragma unroll
        for (int g4 = 0; g4 < 4; ++g4) {
            const int dim = h * 64 + 32 * d0 + 8 * g4 + 4 * hi;
            const u32x2 sg = *(const u32x2*)(F.SG + row * 512 + dim);
            const f32x16& o = d0 ? o1 : o0;
            u32x2 w; w.x = cvtpk(o[4 * g4 + 0] * inv * bflo(sg.x), o[4 * g4 + 1] * inv * bfhi(sg.x)); w.y = cvtpk(o[4 * g4 + 2] * inv * bflo(sg.y), o[4 * g4 + 3] * inv * bfhi(sg.y));
            *(u32x2*)(F.MIX + row * DM + dim) = w;
        }
}

constexpr int DC_RS = 592, DC_QI = 0, DC_KI = 32 * DC_RS  , DC_KB = 64 * DC_RS  ;
__device__ __forceinline__ float sel4(int i, float a, float b, float c, float d) { return i == 0 ? a : i == 1 ? b : i == 2 ? c : d; }
__device__ __forceinline__ void decode_item(Frame& F, int b, int c) {
    const int tid = F.tid, lane = F.lane, r32 = lane & 31, hi = lane >> 5, wid = F.wave, kg = wid & 1, dq = wid >> 1;
    LAS unsigned char* lds = F.lds;
    if (tid < 128) { const int row = tid >> 2, part = tid & 3;
        *(LAS u32x4*)(lds + DC_QI + row * DC_RS + 512 + 16 * part) = *(const u32x4*)(F.QS + (size_t)(4 * b + (row & 3)) * NQ + (row >> 2) * 96 + 64 + 8 * part); }
    {
        const int hd = wid; bf16x8 af[4];
#pragma unroll
        for (int s = 0; s < 4; ++s) af[s] = *(const bf16x8*)(F.QS + (size_t)(4 * b + (r32 & 3)) * NQ + (r32 >> 2) * 96 + 16 * s + 8 * hi);
#pragma unroll 2
        for (int ct = 0; ct < 8; ++ct) {
            f32x16 d = {};
#pragma unroll
            for (int s = 0; s < 4; ++s) { const bf16x8 bw = *(const bf16x8*)(F.WUK + ((size_t)(hd * 256 + 32 * ct + r32)) * 64 + 16 * s + 8 * hi); d = __builtin_amdgcn_mfma_f32_32x32x16_bf16(af[s], bw, d, 0, 0, 0); }
            if (hi == (hd & 1)) {
                const int g = hd >> 1;
#pragma unroll
                for (int tok = 0; tok < 4; ++tok) { const float v = sel4(g, d[tok], d[4 + tok], d[8 + tok], d[12 + tok]);
                    *(LAS bf16_t*)(lds + DC_QI + (4 * hd + tok) * DC_RS + (32 * ct + r32) * 2) = (bf16_t)(cvtpk(v, 0.f) & 0xffffu); }
            }
        }
    }
    f32x4 ck[8], kp;
    const int* ptb = F.pt + b * 128 + 16 * c;
#define DC_LOAD(t) do { const int pg = ptb[(t) >> 1]; const float* cb = F.cckv + ((size_t)pg * 128 + ((t) & 1) * 64) * 256; const float* pb = F.ckpe + ((size_t)pg * 128 + ((t) & 1) * 64) * 32; \
        _Pragma("unroll") for (int i = 0; i < 8; ++i) ck[i] = __builtin_nontemporal_load((const f32x4*)(cb + (size_t)(8 * i + wid) * 256 + 4 * lane)); kp = __builtin_nontemporal_load((const f32x4*)(pb + 4 * tid)); } while (0)
#define DC_WRITE(buf) do { LAS unsigned char* kb_ = lds + DC_KI + (buf) * DC_KB; \
        _Pragma("unroll") for (int i = 0; i < 8; ++i) { u32x2 w_; w_.x = cvtpk(ck[i][0], ck[i][1]); w_.y = cvtpk(ck[i][2], ck[i][3]); *(LAS u32x2*)(kb_ + (8 * i + wid) * DC_RS + 8 * lane) = w_; } \
        { u32x2 w_; w_.x = cvtpk(kp[0], kp[1]); w_.y = cvtpk(kp[2], kp[3]); *(LAS u32x2*)(kb_ + (tid >> 3) * DC_RS + 512 + (tid & 7) * 8) = w_; } } while (0)
    DC_LOAD(0); DC_WRITE(0); DC_LOAD(1);
    __syncthreads();
    float m_run = -INFINITY, l_run = 0.f; f32x16 o0 = {}, o1 = {};
    const LAS unsigned char* qb_ = lds + DC_QI + r32 * DC_RS + 16 * hi;
    const int vtoff = (32 * kg + 4 * hi + ((lane & 15) >> 2)) * DC_RS + (64 * dq + 16 * ((lane >> 4) & 1) + 4 * (lane & 3)) * 2;
    constexpr int NT = 32;
    for (int t = 0; t < NT; ++t) {
        const int buf = t & 1;
        {
            const LAS unsigned char* kb = lds + DC_KI + buf * DC_KB + (32 * kg + r32) * DC_RS + 16 * hi;
            f32x16 p = {};
#pragma unroll
            for (int s = 0; s < 18; ++s) p = __builtin_amdgcn_mfma_f32_32x32x16_bf16(*(const LAS bf16x8*)(kb + 32 * s), *(const LAS bf16x8*)(qb_ + 32 * s), p, 0, 0, 0);
            float mx = p[0];
#pragma unroll
            for (int r = 1; r < 16; ++r) mx = fmaxf(mx, p[r]);
            mx = fmaxf(mx, __shfl_xor(mx, 32));
            const float mn = fmaxf(m_run, mx), alpha = fexp2(m_run - mn);
            float ls = 0.f;
#pragma unroll
            for (int r = 0; r < 16; ++r) { p[r] = fexp2(p[r] - mn); ls += p[r]; }
            l_run = l_run * alpha + ls; m_run = mn; o0 = o0 * alpha; o1 = o1 * alpha;
            const bf16x8 pa0 = pack8(p, 0), pa1 = pack8(p, 8);
            const LAS unsigned char* vb = lds + DC_KI + buf * DC_KB + vtoff;
            o0 = __builtin_amdgcn_mfma_f32_32x32x16_bf16(vtr2(vb, vb + 8 * DC_RS), pa0, o0, 0, 0, 0);
            o0 = __builtin_amdgcn_mfma_f32_32x32x16_bf16(vtr2(vb + 16 * DC_RS, vb + 24 * DC_RS), pa1, o0, 0, 0, 0);
            o1 = __builtin_amdgcn_mfma_f32_32x32x16_bf16(vtr2(vb + 64, vb + 64 + 8 * DC_RS), pa0, o1, 0, 0, 0);
            o1 = __builtin_amdgcn_mfma_f32_32x32x16_bf16(vtr2(vb + 64 + 16 * DC_RS, vb + 64 + 24 * DC_RS), pa1, o1, 0, 0, 0);
        }
        if (t + 1 < NT) { DC_WRITE((t + 1) & 1); if (t + 2 < NT) DC_LOAD(t + 2); }
        __syncthreads();
    }
#undef DC_LOAD
#undef DC_WRITE
    if (c == 7) {
        for (int i = tid; i < 32 * 37; i += 512) { const int row = i / 37, part = i % 37; u32x4 v = (u32x4){0u, 0u, 0u, 0u};
            if (row < 4) { if (part < 32) v = *(const u32x4*)(F.CKV + (size_t)(MP + 4 * b + row) * KVL + 8 * part); else if (part < 36) v = *(const u32x4*)(F.KPES + (size_t)(4 * b + row) * 32 + 8 * (part - 32)); }
            *(LAS u32x4*)(lds + DC_KI + row * DC_RS + 16 * part) = v; }
        __syncthreads();
        if (kg == 0) {
            const LAS unsigned char* kb = lds + DC_KI + r32 * DC_RS + 16 * hi;
            f32x16 p = {};
#pragma unroll
            for (int s = 0; s < 18; ++s) p = __builtin_amdgcn_mfma_f32_32x32x16_bf16(*(const LAS bf16x8*)(kb + 32 * s), *(const LAS bf16x8*)(qb_ + 32 * s), p, 0, 0, 0);
            const int tok = r32 & 3;
#pragma unroll
            for (int r = 0; r < 16; ++r) { const int key = crow(r, hi); if (key > tok) p[r] = -INFINITY; }
            float mx = p[0];
#pragma unroll
            for (int r = 1; r < 16; ++r) mx = fmaxf(mx, p[r]);
            mx = fmaxf(mx, __shfl_xor(mx, 32));
            const float mn = fmaxf(m_run, mx), alpha = fexp2(m_run - mn);
            float ls = 0.f;
#pragma unroll
            for (int r = 0; r < 16; ++r) { p[r] = fexp2(p[r] - mn); ls += p[r]; }
            l_run = l_run * alpha + ls; m_run = mn; o0 = o0 * alpha; o1 = o1 * alpha;
            const bf16x8 pa0 = pack8(p, 0), pa1 = pack8(p, 8);
            const LAS unsigned char* vb = lds + DC_KI + vtoff;
            o0 = __builtin_amdgcn_mfma_f32_32x32x16_bf16(vtr2(vb, vb + 8 * DC_RS), pa0, o0, 0, 0, 0);
            o0 = __builtin_amdgcn_mfma_f32_32x32x16_bf16(vtr2(vb + 16 * DC_RS, vb + 24 * DC_RS), pa1, o0, 0, 0, 0);
            o1 = __builtin_amdgcn_mfma_f32_32x32x16_bf16(vtr2(vb + 64, vb + 64 + 8 * DC_RS), pa0, o1, 0, 0, 0);
            o1 = __builtin_amdgcn_mfma_f32_32x32x16_bf16(vtr2(vb + 64 + 16 * DC_RS, vb + 64 + 24 * DC_RS), pa1, o1, 0, 0, 0);
        }
        __syncthreads();
    }
    float l_tot = l_run + __shfl_xor(l_run, 32);
    LAS float* mg = (LAS float*)(lds + DC_KI) + dq * (34 * 64);
    if (kg == 1) { mg[lane] = m_run; mg[64 + lane] = l_tot;
#pragma unroll
        for (int r = 0; r < 16; ++r) { mg[(2 + r) * 64 + lane] = o0[r]; mg[(18 + r) * 64 + lane] = o1[r]; } }
    __syncthreads();
    if (kg == 0) {
        const float m1 = mg[lane], l1 = mg[64 + lane], M = fmaxf(m_run, m1), a0 = fexp2(m_run - M), a1 = fexp2(m1 - M);
        l_tot = l_tot * a0 + l1 * a1;
        float* po = F.PO + ((size_t)(b * 8 + c) * 32 + r32) * 256 + 64 * dq + 4 * hi;
#pragma unroll
        for (int g4 = 0; g4 < 4; ++g4) {
            f32x4 v0, v1;
#pragma unroll
            for (int e = 0; e < 4; ++e) { v0[e] = o0[4 * g4 + e] * a0 + mg[(2 + 4 * g4 + e) * 64 + lane] * a1; v1[e] = o1[4 * g4 + e] * a0 + mg[(18 + 4 * g4 + e) * 64 + lane] * a1; }
            *(f32x4*)(po + 8 * g4) = v0; *(f32x4*)(po + 32 + 8 * g4) = v1;
        }
        if (dq == 0 && hi == 0) { F.PML[((size_t)(b * 8 + c) * 32 + r32) * 2] = M; F.PML[((size_t)(b * 8 + c) * 32 + r32) * 2 + 1] = l_tot; }
    }
    __syncthreads();
}

__device__ __forceinline__ void decode_combine(Frame& F, int b) {
    const int tid = F.tid; LAS float* OL = (LAS float*)F.lds;
    for (int idx = tid; idx < 32 * 64; idx += 512) {
        const int q = idx >> 6, d4 = idx & 63; float mv[8], lv[8], M = -INFINITY;
#pragma unroll
        for (int c = 0; c < 8; ++c) { mv[c] = F.PML[((size_t)(b * 8 + c) * 32 + q) * 2]; lv[c] = F.PML[((size_t)(b * 8 + c) * 32 + q) * 2 + 1]; M = fmaxf(M, mv[c]); }
        float L = 0.f; f32x4 a = {0.f, 0.f, 0.f, 0.f};
#pragma unroll
        for (int c = 0; c < 8; ++c) { const float w = fexp2(mv[c] - M); L += lv[c] * w; a += *(const f32x4*)(F.PO + ((size_t)(b * 8 + c) * 32 + q) * 256 + 4 * d4) * w; }
        *(LAS f32x4*)(OL + q * 256 + 4 * d4) = a * (1.0f / L);
    }
    __syncthreads();
    { const int h = tid >> 6, v = tid & 63; float o[4] = {0.f, 0.f, 0.f, 0.f};
      const float* wp = F.wukv + h * 128 + 64 + v;
#pragma unroll 4
      for (int cc = 0; cc < 256; ++cc) { const float w = wp[(size_t)cc * NKV];
#pragma unroll
          for (int tok = 0; tok < 4; ++tok) o[tok] += OL[(4 * h + tok) * 256 + cc] * w; }
#pragma unroll
      for (int tok = 0; tok < 4; ++tok) { const size_t r = MP + 4 * b + tok; F.MIX[r * DM + h * 64 + v] = (bf16_t)(cvtpk(o[tok] * bf2f(F.SG[r * 512 + h * 64 + v]), 0.f) & 0xffffu); }
    }
    __syncthreads();
}

__device__ __forceinline__ void final_rows(Frame& F, int w0, int nw) {
    const int lane = F.lane; float* Y = F.out + O_YP;
    f32x4 g[4];
#pragma unroll
    for (int j = 0; j < 4; ++j) g[j] = *(const f32x4*)(F.gpost + 4 * (64 * j + lane));
    for (int r = w0; r < MP; r += nw) {
        const f32x4* sp = (const f32x4*)(F.SSQT + (size_t)r * 16); const f32x4 s0 = sp[0], s1 = sp[1], s2 = sp[2], s3 = sp[3];
        const float tot = ((s0[0] + s0[1]) + (s0[2] + s0[3])) + ((s1[0] + s1[1]) + (s1[2] + s1[3])) + ((s2[0] + s2[1]) + (s2[2] + s2[3])) + ((s3[0] + s3[1]) + (s3[2] + s3[3]));
        const float inv = rsqrtf(tot * (1.0f / DM) + EPS);
#pragma unroll
        for (int j = 0; j < 4; ++j) { const size_t o = (size_t)r * DM + 4 * (64 * j + lane); const f32x4 x = *(const f32x4*)(F.xp + o), tv = *(const f32x4*)(Y + o); *(f32x4*)(Y + o) = x + tv * inv * g[j]; }
    }
}
__device__ __forceinline__ void sample_tail(Frame& F, int wg) {
    const int lane = F.lane, wid = F.wave, l15 = lane & 15, kq = lane >> 4;
    const bf16_t* Ar = F.MIX + (size_t)(MP + 16 * wg + l15) * DM + 8 * kq;
    const bf16_t* Br = F.WOUT + (size_t)(128 * wid + l15) * DM + 8 * kq;
    f32x4 acc[8];
#pragma unroll
    for (int n = 0; n < 8; ++n) acc[n] = (f32x4){0.f, 0.f, 0.f, 0.f};
#pragma unroll 2
    for (int s = 0; s < 32; ++s) {
        const bf16x8 a = *(const bf16x8*)(Ar + 32 * s);
#pragma unroll
        for (int n = 0; n < 8; ++n) { const bf16x8 bw = *(const bf16x8*)(Br + (size_t)(16 * n) * DM + 32 * s); acc[n] = __builtin_amdgcn_mfma_f32_16x16x32_bf16(a, bw, acc[n], 0, 0, 0); }
    }
    LAS float* red = (LAS float*)F.lds;
    float ss[4];
#pragma unroll
    for (int e = 0; e < 4; ++e) { float s = 0.f;
#pragma unroll
        for (int n = 0; n < 8; ++n) s += acc[n][e] * acc[n][e];
        s += __shfl_xor(s, 1); s += __shfl_xor(s, 2); s += __shfl_xor(s, 4); s += __shfl_xor(s, 8); ss[e] = s; }
    if (l15 == 0) {
#pragma unroll
        for (int e = 0; e < 4; ++e) red[wid * 16 + 4 * kq + e] = ss[e]; }
    __syncthreads();
#pragma unroll
    for (int e = 0; e < 4; ++e) { const int row = 4 * kq + e; float tot = 0.f;
#pragma unroll
        for (int w = 0; w < 8; ++w) tot += red[w * 16 + row];
        const float inv = rsqrtf(tot * (1.0f / DM) + EPS); const size_t rs = (size_t)(16 * wg + row);
#pragma unroll
        for (int n = 0; n < 8; ++n) { const int col = 128 * wid + 16 * n + l15; F.out[O_YS + rs * DM + col] = F.xs[rs * DM + col] + acc[n][e] * inv * F.gpost[col]; } }
    __syncthreads();
}

__global__ void __launch_bounds__(512, 2) mega(Params P) {
    extern __shared__ __attribute__((aligned(16))) unsigned char lds_raw[];
    Frame F;
    F.lds = (LAS unsigned char*)lds_raw;
    F.tid = threadIdx.x; F.lane = F.tid & 63; F.wave = __builtin_amdgcn_readfirstlane(F.tid >> 6);
    F.G = gridDim.x; { const int bx = blockIdx.x; F.vcu = (F.G % 8 == 0) ? (bx % 8) * (F.G / 8) + bx / 8 : bx; }
    F.xp = (const float*)P.in[0]; F.xs = (const float*)P.in[1]; F.cckv = (const float*)P.in[2]; F.ckpe = (const float*)P.in[3]; F.sconv = (const float*)P.in[4]; F.pt = (const int*)P.in[5];
    F.gpre = (const float*)P.in[6]; F.win = (const float*)P.in[7]; F.gq = (const float*)P.in[8]; F.wuq = (const float*)P.in[9]; F.gkv = (const float*)P.in[10]; F.wukv = (const float*)P.in[11];
    F.wconv = (const float*)P.in[12]; F.wout = (const float*)P.in[13]; F.gpost = (const float*)P.in[14]; F.out = P.out;
    unsigned char* ws = P.ws;
    F.rope = (f32x2*)(ws + WS_ROPE); F.WIN = (bf16_t*)(ws + WS_WIN); F.WUQ = (bf16_t*)(ws + WS_WUQ); F.WUKV = (bf16_t*)(ws + WS_WUKV); F.WOUT = (bf16_t*)(ws + WS_WOUT); F.WUK = (bf16_t*)(ws + WS_WUK);
    F.SSQQ = (float*)(ws + WS_SSQQ); F.SSQT = (float*)(ws + WS_SSQT); F.QS = (bf16_t*)(ws + WS_QS); F.KPES = (bf16_t*)(ws + WS_KPES); F.PML = (float*)(ws + WS_PML); F.PO = (float*)(ws + WS_PO);
    F.XN = (bf16_t*)(ws + WS_XN); F.CQ = (bf16_t*)(ws + WS_CQ); F.CKV = (bf16_t*)(ws + WS_CKV); F.SG = (bf16_t*)(ws + WS_SG); F.BG = (bf16_t*)(ws + WS_BG); F.U = (bf16_t*)(ws + WS_U);
    F.Q = (bf16_t*)(ws + WS_Q); F.K = (bf16_t*)(ws + WS_K); F.V = (bf16_t*)(ws + WS_V); F.MIX = (bf16_t*)(ws + WS_MIX);

    volatile LAS unsigned* misc = (volatile LAS unsigned*)(F.lds + MISC_OFF);
    if (F.tid < 16) misc[F.tid] = 0u;
    __syncthreads();
    const int lo = P.ph_lo, hi = P.ph_hi;
    XcdBarrier bar; bar.bar = (unsigned*)(ws + WS_CTL) + 4096; bar.x = 0; bar.st = nullptr;
    if (hi - lo > 1) bar = xcd_barrier_post((unsigned*)(ws + WS_CTL) + 4096, misc + 8);
#define IN(k) (lo <= (k) && (k) < hi)
#define SEAM(k) do { if (IN(k) && IN((k) + 1)) xcd_barrier(bar); } while (0)

    if (IN(0)) { p0_prep(F); SEAM(0); }
    if (IN(1)) {
        pg8::Gemm g{F.XN, F.WIN, MTOT, NZ, DM}; pg8::StaticOrder S; S.init(MTOT, NZ, F.G, (int)blockIdx.x);
        EpiZ E{F.CQ, F.CKV, F.SG, F.BG, F.U, F.K, F.KPES, F.SSQQ, F.gkv, F.rope, F.out, (LAS float*)(F.lds + XL_OFF)};
        pg8::gemm_phase<EpiZ, pg8::StaticOrder, true, true>(F.lds, g, S, E);
        SEAM(1);
    }
    if (IN(2)) {
        conv_rows(F);
        { pg8::Gemm g{F.CQ, F.WUQ, MTOT, NQ, QL}; pg8::StaticOrder S; S.init(MTOT, NQ, F.G, (int)blockIdx.x);
          EpiQ E{F.Q, F.QS, F.SSQQ, F.rope};
          pg8::gemm_phase<EpiQ, pg8::StaticOrder, true, true>(F.lds, g, S, E); }
        { pg8::Gemm g{F.CKV, F.WUKV, MP, NKV, KVL}; pg8::StaticOrder S; S.init(MP, NKV, F.G, (int)blockIdx.x);
          EpiKV E{F.K, F.V};
          pg8::gemm_phase<EpiKV, pg8::StaticOrder, true, true>(F.lds, g, S, E); }
        SEAM(2);
    }
    if (IN(3)) {
        for (int it = F.vcu; it < 256; it += F.G) decode_item(F, it >> 3, it & 7);
        for (int it = F.vcu; it < 256; it += F.G) { const int bh = it >> 2, pr = it & 3; attn_unit(F, bh >> 3, bh & 7, 7 - pr); attn_unit(F, bh >> 3, bh & 7, pr); }
        SEAM(3);
    }
    if (IN(4)) {
        for (int b = F.vcu; b < 32; b += F.G) decode_combine(F, b);
        pg8::Gemm g{F.MIX, F.WOUT, MP, DM, DM}; pg8::StaticOrder S; S.init(MP, DM, F.G, (int)blockIdx.x);
        EpiOut E{F.out + O_YP, F.SSQT};
        pg8::gemm_phase<EpiOut, pg8::StaticOrder, true, true>(F.lds, g, S, E);
        SEAM(4);
    }
    if (IN(5)) {
        if (F.G >= 64 && F.vcu < 8) sample_tail(F, F.vcu);
        else { const int nwg = F.G >= 64 ? F.G - 8 : F.G, wg = F.G >= 64 ? F.vcu - 8 : F.vcu; final_rows(F, wg * 8 + F.wave, nwg * 8);
               if (F.G < 64) for (int w = F.vcu; w < 8; w += F.G) sample_tail(F, w); }
    }
#undef IN
#undef SEAM
}

extern "C" void kernel_launch(void* const* d_in, const int* in_sizes, int n_in, void* d_out, int out_size, void* d_ws, size_t ws_size, hipStream_t stream) {
    static int grid = 0;
    if (grid == 0) {
        int dev = 0, cus = 0;
        if (n_in != 15 || ws_size < WS_END) { fprintf(stderr, "kernel_launch: unexpected n_in %d / ws %zu\n", n_in, ws_size); grid = -1; return; }
        if (hipGetDevice(&dev) != hipSuccess || hipDeviceGetAttribute(&cus, hipDeviceAttributeMultiprocessorCount, dev) != hipSuccess) { grid = -1; return; }
        if (hipFuncSetAttribute((const void*)mega, hipFuncAttributeMaxDynamicSharedMemorySize, LDS_BYTES) != hipSuccess) { fprintf(stderr, "kernel_launch: hipFuncSetAttribute failed\n"); grid = -1; return; }
        (void)hipGetLastError();
        grid = cus;
    }
    if (grid < 0) return;
    (void)hipMemsetAsync((char*)d_ws + WS_CTL, 0, CTL_BYTES, stream);
    Params p{};
    for (int i = 0; i < 15; ++i) p.in[i] = d_in[i];
    p.out = (float*)d_out; p.ws = (unsigned char*)d_ws;
    if (MK_N_LAUNCHES == 1) { p.ph_lo = 0; p.ph_hi = N_PHASES; hipLaunchKernelGGL(mega, dim3(grid), dim3(512), LDS_BYTES, stream, p); }
    else for (int k = 0; k < N_PHASES; ++k) { p.ph_lo = k; p.ph_hi = k + 1; hipLaunchKernelGGL(mega, dim3(grid), dim3(512), LDS_BYTES, stream, p); }
}
```
